# Optimizing an MI355X kernel written in HIP

```python
import math
import jax, jax.numpy as jnp
from jax import lax
import numpy as np

D_MODEL = 2048
BATCH = 1
SEQ = 8192
DEPTH = 1

HEAD_DIM = 128
N_Q_HEADS = 8
N_KV_HEADS = 2
GQA_GROUP = N_Q_HEADS // N_KV_HEADS
ATTN_WIDTH = N_Q_HEADS * HEAD_DIM
KV_WIDTH = N_KV_HEADS * HEAD_DIM
WINDOW = 128
BLOCK = 128
SPAN = BLOCK + 2 * WINDOW
N_BUCKETS = 32
MAX_DISTANCE = 128
POOL_SIZES = (2, 4, 8, 16)
N_POOL_GROUPS = len(POOL_SIZES)
POOL_WIDTH = D_MODEL // 2
POOL_GROUP_WIDTH = POOL_WIDTH // N_POOL_GROUPS
SPLIT_WIDTHS = (ATTN_WIDTH, KV_WIDTH, KV_WIDTH, ATTN_WIDTH, POOL_WIDTH, POOL_WIDTH)
SPLIT_POINTS = tuple(int(s) for s in np.cumsum(SPLIT_WIDTHS)[:-1])
IN_WIDTH = int(sum(SPLIT_WIDTHS))
N_BRANCHES = 2
EPS = 1e-6
NEG_INF = -1e30

kernel_name = "hybrid_swa_pool_gated_encoder"


def rmsnorm(x, g):
    xf = x.astype(jnp.float32)
    xf = xf * lax.rsqrt(jnp.mean(xf * xf, axis=-1, keepdims=True) + EPS)
    return xf.astype(x.dtype) * g


def t5_bucket(rel):
    half = N_BUCKETS // 2
    max_exact = half // 2
    ret = jnp.where(rel > 0, half, 0)
    n = jnp.abs(rel)
    nf = jnp.maximum(n, 1).astype(jnp.float32)
    large = max_exact + (jnp.log(nf / max_exact) / math.log(MAX_DISTANCE / max_exact)
                         * (half - max_exact)).astype(jnp.int32)
    large = jnp.minimum(large, half - 1)
    return ret + jnp.where(n < max_exact, n, large)


def windowed_gqa(q, k, v, rel_table, sink):
    B, S, _ = q.shape
    nblk = S // BLOCK
    qb = q.reshape(B, nblk, BLOCK, N_KV_HEADS, GQA_GROUP, HEAD_DIM)
    pad = ((0, 0), (WINDOW, WINDOW), (0, 0), (0, 0))
    kp = jnp.pad(k.reshape(B, S, N_KV_HEADS, HEAD_DIM), pad)
    vp = jnp.pad(v.reshape(B, S, N_KV_HEADS, HEAD_DIM), pad)
    idx = jnp.arange(nblk)[:, None] * BLOCK + jnp.arange(SPAN)[None, :]
    kw = kp[:, idx]
    vw = vp[:, idx]
    logits = jnp.einsum('bnqkgd,bntkd->bnkgqt', qb, kw).astype(jnp.float32) * (HEAD_DIM ** -0.5)
    rel = jnp.arange(SPAN)[None, :] - WINDOW - jnp.arange(BLOCK)[:, None]
    bias = rel_table[t5_bucket(rel)]
    bias = jnp.transpose(bias, (2, 0, 1)).reshape(N_KV_HEADS, GQA_GROUP, BLOCK, SPAN)
    key_pos = idx - WINDOW
    key_ok = (key_pos >= 0) & (key_pos < S)
    valid = (jnp.abs(rel) <= WINDOW)[None] & key_ok[:, None, :]
    logits = jnp.where(valid[None, :, None, None], logits + bias.astype(jnp.float32), NEG_INF)
    sink_l = jnp.broadcast_to(sink.astype(jnp.float32).reshape(N_KV_HEADS, GQA_GROUP, 1, 1),
                              logits.shape[:-1] + (1,))
    probs = jax.nn.softmax(jnp.concatenate([logits, sink_l], axis=-1), axis=-1)[..., :-1]
    out = jnp.einsum('bnkgqt,bntkd->bnqkgd', probs.astype(vw.dtype), vw)
    return out.reshape(B, S, ATTN_WIDTH)


def multiscale_pool(u, w_grp, scale):
    B, S, _ = u.shape
    ug = u.reshape(B, S, N_POOL_GROUPS, POOL_GROUP_WIDTH).astype(jnp.float32)
    cs = jnp.pad(jnp.cumsum(ug, axis=1), ((0, 0), (1, 0), (0, 0), (0, 0)))
    pos = jnp.arange(S)
    outs = []
    for gi, w in enumerate(POOL_SIZES):
        lo = jnp.clip(pos - w // 2, 0, S)
        hi = jnp.clip(pos + w // 2, 0, S)
        cnt = (hi - lo).astype(jnp.float32)[None, :, None]
        outs.append((cs[:, hi, gi] - cs[:, lo, gi]) / cnt - ug[:, :, gi])
    pooled = jnp.stack(outs, axis=2).astype(u.dtype)
    mixed = jnp.einsum('bsgc,gcd->bsgd', pooled, w_grp).reshape(B, S, POOL_WIDTH)
    return mixed * scale


def hybrid_layer(x, c, rel_table, w_ada, b_ada, pre_g, post_g, w_in, sink,
                 w_pool_grp, pool_scale, w_br_attn, w_br_pool, w_merge, b_merge, w_out):
    mod = jax.nn.silu(c) @ w_ada + b_ada
    shift, scale, gate = jnp.split(mod, 3, axis=-1)
    h = rmsnorm(x, pre_g) * (1.0 + scale[:, None]) + shift[:, None]
    proj = h @ w_in
    q, k, v, gate_a, u, gate_p = jnp.split(proj, SPLIT_POINTS, axis=-1)
    y_a = windowed_gqa(q, k, v, rel_table, sink) * jax.nn.silu(gate_a)
    y_p = multiscale_pool(u, w_pool_grp, pool_scale) * jax.nn.silu(gate_p)
    g = jax.nn.sigmoid(h @ w_merge + b_merge)
    g_a, g_p = jnp.split(g, N_BRANCHES, axis=-1)
    merged = g_a * (y_a @ w_br_attn) + g_p * (y_p @ w_br_pool)
    o = merged @ w_out
    return x + gate[:, None] * rmsnorm(o, post_g)


def setup_inputs(seed: int = 0) -> dict:
    key = jax.random.key(seed)
    ks = jax.random.split(key, 18)
    D = D_MODEL
    nrm = lambda k, shape, s: jax.random.normal(k, shape, jnp.float32) * s
    return {
        "x": nrm(ks[0], (BATCH, SEQ, D), 1.0),
        "c": nrm(ks[1], (BATCH, D), 1.0),
        "rel_bias_table": nrm(ks[2], (N_BUCKETS, N_Q_HEADS), 0.5),
        "w_ada": nrm(ks[3], (DEPTH, D, 3 * D), 0.1 * D ** -0.5),
        "b_ada": nrm(ks[4], (DEPTH, 3 * D), 0.02),
        "pre_norm_g": 1.0 + nrm(ks[5], (DEPTH, D), 0.05),
        "post_norm_g": 1.0 + nrm(ks[6], (DEPTH, D), 0.05),
        "w_in": nrm(ks[7], (DEPTH, D, IN_WIDTH), D ** -0.5),
        "attn_sink": nrm(ks[8], (DEPTH, N_Q_HEADS), 0.5),
        "w_pool_group": nrm(ks[9], (DEPTH, N_POOL_GROUPS, POOL_GROUP_WIDTH, POOL_GROUP_WIDTH),
                            POOL_GROUP_WIDTH ** -0.5),
        "pool_scale": 1.0 + nrm(ks[10], (DEPTH, POOL_WIDTH), 0.1),
        "w_branch_attn": nrm(ks[11], (DEPTH, ATTN_WIDTH, D), ATTN_WIDTH ** -0.5),
        "w_branch_pool": nrm(ks[12], (DEPTH, POOL_WIDTH, D), POOL_WIDTH ** -0.5),
        "w_merge": nrm(ks[13], (DEPTH, D, N_BRANCHES * D), D ** -0.5),
        "b_merge": nrm(ks[14], (DEPTH, N_BRANCHES * D), 0.02),
        "w_out": nrm(ks[15], (DEPTH, D, D), D ** -0.5),
    }


def reference(x, c, rel_bias_table, w_ada, b_ada, pre_norm_g, post_norm_g, w_in, attn_sink,
              w_pool_group, pool_scale, w_branch_attn, w_branch_pool, w_merge, b_merge, w_out):
    for l in range(DEPTH):
        x = hybrid_layer(x, c, rel_bias_table, w_ada[l], b_ada[l], pre_norm_g[l], post_norm_g[l],
                         w_in[l], attn_sink[l], w_pool_group[l], pool_scale[l],
                         w_branch_attn[l], w_branch_pool[l], w_merge[l], b_merge[l], w_out[l])
    return x
```

```cpp
#include <hip/hip_runtime.h>
#include <cstdio>
#include <cstdint>

constexpr int S = 8192, D = 2048, INW = 4608, NQH = 8, HD = 128, WIN = 128;
constexpr int C_Q = 0, C_K = 1024, C_V = 1280, C_GA = 1536, C_U = 2560, C_GP = 3584;
constexpr float EPS = 1e-6f;

__device__ __forceinline__ float sigmoidf_(float v) { return 1.f / (1.f + __expf(-v)); }
__device__ __forceinline__ float siluf_(float v) { return v * sigmoidf_(v); }

__global__ void k_mod(const float* __restrict__ c, const float* __restrict__ w, const float* __restrict__ b, float* __restrict__ mod) {
    const int n = blockIdx.x * blockDim.x + threadIdx.x;
    float acc = 0.f;
    for (int k = 0; k < D; ++k) acc += siluf_(c[k]) * w[(size_t)k * (3 * D) + n];
    mod[n] = acc + b[n];
}

__device__ __forceinline__ float block_sum256(float v, float* red) {
    for (int o = 32; o > 0; o >>= 1) v += __shfl_xor(v, o);
    const int w = threadIdx.x >> 6;
    __syncthreads();
    if ((threadIdx.x & 63) == 0) red[w] = v;
    __syncthreads();
    return red[0] + red[1] + red[2] + red[3];
}

__global__ void k_h(const float* __restrict__ x, const float* __restrict__ pre_g, const float* __restrict__ mod, float* __restrict__ h) {
    __shared__ float red[4];
    const int row = blockIdx.x;
    const float* xr = x + (size_t)row * D;
    float ss = 0.f;
    for (int i = threadIdx.x; i < D; i += 256) { const float v = xr[i]; ss += v * v; }
    ss = block_sum256(ss, red);
    const float rstd = rsqrtf(ss / D + EPS);
    for (int i = threadIdx.x; i < D; i += 256) h[(size_t)row * D + i] = (xr[i] * rstd) * pre_g[i] * (1.f + mod[D + i]) + mod[i];
}

__global__ void k_gemm(const float* __restrict__ A, int lda, const float* __restrict__ B, int ldb, float* C, int ldc, int K, int mode,
                       const float* __restrict__ bias, const float* __restrict__ Dm, int ldd) {
    __shared__ float As[16][64 + 1], Bs[16][64 + 1];
    const int tx = threadIdx.x & 15, ty = threadIdx.x >> 4;
    const int row0 = blockIdx.y * 64, col0 = blockIdx.x * 64;
    float acc[4][4] = {};
    for (int k0 = 0; k0 < K; k0 += 16) {
        for (int i = threadIdx.x; i < 64 * 16; i += 256) { const int r = i >> 4, kk = i & 15; As[kk][r] = A[(size_t)(row0 + r) * lda + k0 + kk]; }
        for (int i = threadIdx.x; i < 16 * 64; i += 256) { const int kk = i >> 6, cc = i & 63; Bs[kk][cc] = B[(size_t)(k0 + kk) * ldb + col0 + cc]; }
        __syncthreads();
#pragma unroll
        for (int kk = 0; kk < 16; ++kk) {
            float a[4], b[4];
#pragma unroll
            for (int i = 0; i < 4; ++i) { a[i] = As[kk][ty * 4 + i]; b[i] = Bs[kk][tx * 4 + i]; }
#pragma unroll
            for (int i = 0; i < 4; ++i)
#pragma unroll
                for (int j = 0; j < 4; ++j) acc[i][j] += a[i] * b[j];
        }
        __syncthreads();
    }
#pragma unroll
    for (int i = 0; i < 4; ++i)
#pragma unroll
        for (int j = 0; j < 4; ++j) {
            const int r = row0 + ty * 4 + i, cidx = col0 + tx * 4 + j;
            float v = acc[i][j];
            if (mode >= 1) { v = sigmoidf_(v + bias[cidx]) * C[(size_t)r * ldc + cidx]; if (mode == 2) v += Dm[(size_t)r * ldd + cidx]; }
            C[(size_t)r * ldc + cidx] = v;
        }
}

__device__ __forceinline__ int t5_bucket(int rel) {
    const int n = rel < 0 ? -rel : rel;
    int b;
    if (n < 8) b = n;
    else { int j = 0; while (j < 7 && n * n >= (64 << (j + 1))) ++j; b = 8 + j; }
    return b + (rel > 0 ? 16 : 0);
}

__global__ void k_attn(float* proj, const float* __restrict__ rel_table, const float* __restrict__ sink) {
    __shared__ float ps[4][320];
    __shared__ float qs[4][128];
    const int w = threadIdx.x >> 6, lane = threadIdx.x & 63;
    const int gw = blockIdx.x * 4 + w, s = gw >> 3, hq = gw & 7, kvh = hq >> 2;
    const float* qrow = proj + (size_t)s * INW + C_Q + hq * HD;
    qs[w][lane] = qrow[lane]; qs[w][lane + 64] = qrow[lane + 64];
    __syncthreads();
    float lg[5]; float m = sink[hq];
#pragma unroll
    for (int t = 0; t < 5; ++t) {
        const int j = s - WIN + lane + 64 * t; const int rel = j - s;
        float l = -1e30f; bool ok = (rel <= WIN) && (j >= 0) && (j < S);
        if (ok) { const float* kr = proj + (size_t)j * INW + C_K + kvh * HD; float a = 0.f;
#pragma unroll 8
            for (int d = 0; d < HD; ++d) a += qs[w][d] * kr[d];
            l = a * 0.08838834764831845f + rel_table[t5_bucket(rel) * NQH + hq]; }
        lg[t] = l; m = fmaxf(m, l);
    }
    for (int o = 32; o > 0; o >>= 1) m = fmaxf(m, __shfl_xor(m, o));
    float sum = 0.f;
#pragma unroll
    for (int t = 0; t < 5; ++t) { const float p = (lg[t] > -1e29f) ? __expf(lg[t] - m) : 0.f; ps[w][lane + 64 * t] = p; sum += p; }
    for (int o = 32; o > 0; o >>= 1) sum += __shfl_xor(sum, o);
    sum += __expf(sink[hq] - m);
    __syncthreads();
    float a0 = 0.f, a1 = 0.f;
#pragma unroll 4
    for (int jj = 0; jj <= 2 * WIN; ++jj) { const int j = s - WIN + jj; if (j < 0 || j >= S) continue;
        const float p = ps[w][jj]; const float* vr = proj + (size_t)j * INW + C_V + kvh * HD; a0 += p * vr[lane]; a1 += p * vr[lane + 64]; }
    const float inv = 1.f / sum;
    const float* ga = proj + (size_t)s * INW + C_GA + hq * HD;
    float* out = proj + (size_t)s * INW + C_Q + hq * HD;
    __syncthreads();
    out[lane] = a0 * inv * siluf_(ga[lane]); out[lane + 64] = a1 * inv * siluf_(ga[lane + 64]);
}

__global__ void k_pool(float* proj) {
    const int idx = blockIdx.x * blockDim.x + threadIdx.x;
    const int s = idx >> 10, col = idx & 1023, g = col >> 8;
    const int w = 2 << g, lo = max(s - w / 2, 0), hi = min(s + w / 2, S);
    float sum = 0.f;
    for (int t = lo; t < hi; ++t) sum += proj[(size_t)t * INW + C_U + col];
    proj[(size_t)s * INW + C_GA + col] = sum / (float)(hi - lo) - proj[(size_t)s * INW + C_U + col];
}
__global__ void k_yp(float* proj, const float* __restrict__ pool_scale) {
    const int idx = blockIdx.x * blockDim.x + threadIdx.x;
    const int s = idx >> 10, col = idx & 1023;
    float* p = proj + (size_t)s * INW;
    p[C_U + col] = p[C_U + col] * pool_scale[col] * siluf_(p[C_GP + col]);
}
__global__ void k_final(const float* __restrict__ x, const float* __restrict__ o, const float* __restrict__ post_g, const float* __restrict__ mod, float* __restrict__ out) {
    __shared__ float red[4];
    const int row = blockIdx.x;
    const float* orow = o + (size_t)row * D;
    float ss = 0.f;
    for (int i = threadIdx.x; i < D; i += 256) { const float v = orow[i]; ss += v * v; }
    ss = block_sum256(ss, red);
    const float rstd = rsqrtf(ss / D + EPS);
    for (int i = threadIdx.x; i < D; i += 256) out[(size_t)row * D + i] = x[(size_t)row * D + i] + mod[2 * D + i] * ((orow[i] * rstd) * post_g[i]);
}

extern "C" void kernel_launch(void* const* d_in, const int* in_sizes, int n_in, void* d_out, int out_size, void* d_ws, size_t ws_size, hipStream_t stream) {
    const float* x = (const float*)d_in[0]; const float* c = (const float*)d_in[1]; const float* rel = (const float*)d_in[2];
    const float* w_ada = (const float*)d_in[3]; const float* b_ada = (const float*)d_in[4]; const float* pre_g = (const float*)d_in[5];
    const float* post_g = (const float*)d_in[6]; const float* w_in = (const float*)d_in[7]; const float* sink = (const float*)d_in[8];
    const float* w_pool = (const float*)d_in[9]; const float* pool_scale = (const float*)d_in[10]; const float* w_ba = (const float*)d_in[11];
    const float* w_bp = (const float*)d_in[12]; const float* w_merge = (const float*)d_in[13]; const float* b_merge = (const float*)d_in[14];
    const float* w_out = (const float*)d_in[15];
    float* out = (float*)d_out;
    float* ws = (float*)d_ws;
    float* h = ws;
    float* proj = ws + (size_t)S * D;
    float* mod = proj + (size_t)S * INW;
    k_mod<<<3 * D / 256, 256, 0, stream>>>(c, w_ada, b_ada, mod);
    k_h<<<S, 256, 0, stream>>>(x, pre_g, mod, h);
    k_gemm<<<dim3(INW / 64, S / 64), 256, 0, stream>>>(h, D, w_in, INW, proj, INW, D, 0, nullptr, nullptr, 0);
    k_attn<<<S * NQH / 4, 256, 0, stream>>>(proj, rel, sink);
    k_pool<<<S * 1024 / 256, 256, 0, stream>>>(proj);
    for (int g = 0; g < 4; ++g)
        k_gemm<<<dim3(256 / 64, S / 64), 256, 0, stream>>>(proj + C_GA + g * 256, INW, w_pool + (size_t)g * 256 * 256, 256, proj + C_U + g * 256, INW, 256, 0, nullptr, nullptr, 0);
    k_yp<<<S * 1024 / 256, 256, 0, stream>>>(proj, pool_scale);
    k_gemm<<<dim3(D / 64, S / 64), 256, 0, stream>>>(proj + C_Q, INW, w_ba, D, out, D, 1024, 0, nullptr, nullptr, 0);
    k_gemm<<<dim3(D / 64, S / 64), 256, 0, stream>>>(h, D, w_merge, 2 * D, out, D, D, 1, b_merge, nullptr, 0);
    k_gemm<<<dim3(D / 64, S / 64), 256, 0, stream>>>(proj + C_U, INW, w_bp, D, proj, INW, 1024, 0, nullptr, nullptr, 0);
    k_gemm<<<dim3(D / 64, S / 64), 256, 0, stream>>>(h, D, w_merge + D, 2 * D, proj, INW, D, 2, b_merge + D, out, D);
    k_gemm<<<dim3(D / 64, S / 64), 256, 0, stream>>>(proj, INW, w_out, D, h, D, D, 0, nullptr, nullptr, 0);
    k_final<<<S, 256, 0, stream>>>(x, h, post_g, mod, out);
}
```
